# Optimizing an MI355X kernel written in HIP

```python
import math
import jax, jax.numpy as jnp
from jax import lax
import numpy as np

D_MODEL = 1024
BATCH = 4
SEQ = 4096
DEPTH = 2
DEC_BATCH = 32
DEC_SEQ = 4
PAST_LEN = 16384
PAGE_SIZE = 128

N_A_LAYERS = DEPTH // 2
N_B_LAYERS = DEPTH - N_A_LAYERS
POOL_WINDOWS = (2, 4, 8, 16)
POOL_GROUPS = len(POOL_WINDOWS)
POOL_GROUP_DIM = D_MODEL // POOL_GROUPS
POOL_PAD = max(POOL_WINDOWS) - 1
DIL_PATTERNS = ((128, 1), (512, 4), (2048, 16))
N_DIL_GROUPS = len(DIL_PATTERNS)
HEAD_DIM = 64
HEADS_PER_GROUP = D_MODEL // 128
N_HEADS = N_DIL_GROUPS * HEADS_PER_GROUP
ATTN_GROUP_WIDTH = HEADS_PER_GROUP * HEAD_DIM
Q_WIDTH = N_DIL_GROUPS * ATTN_GROUP_WIDTH
KV_WIDTH = 2 * Q_WIDTH
N_BUCKETS = 32
MAX_DISTANCE = 2048
D_FF = ((8 * D_MODEL // 3 + 127) // 128) * 128
ALPHA = (2.0 * DEPTH) ** 0.25
BETA = (8.0 * DEPTH) ** -0.25
LN_EPS = 1e-5
Q_BLOCK = 128
NEG = -1e30

kernel_name = 'yoco_pool_dilated_macaron_deepnorm_step'


def t5_buckets(dist):
    dist = np.asarray(dist, dtype=np.int64)
    max_exact = N_BUCKETS // 2
    ratio = np.maximum(dist, 1).astype(np.float64) / max_exact
    large = max_exact + (np.log(ratio) / np.log(MAX_DISTANCE / max_exact) * (N_BUCKETS - max_exact)).astype(np.int64)
    large = np.minimum(large, N_BUCKETS - 1)
    return np.where(dist < max_exact, dist, large).astype(np.int32)


def layer_norm(x, g, b):
    xf = x.astype(jnp.float32)
    mu = jnp.mean(xf, axis=-1, keepdims=True)
    var = jnp.mean(jnp.square(xf - mu), axis=-1, keepdims=True)
    y = (xf - mu) * lax.rsqrt(var + LN_EPS) * g.astype(jnp.float32) + b.astype(jnp.float32)
    return y.astype(x.dtype)


def swiglu(x, w13, w2):
    gate, up = jnp.split(x @ w13, 2, axis=-1)
    return (jax.nn.silu(gate) * up) @ w2


def pool_mixer(x, prefix, pos0, w_in, w_grp, scale, w_out):
    n = x.shape[1]
    u = x @ w_in
    u_ext = jnp.concatenate([prefix.astype(u.dtype), u], axis=1)
    csum = jnp.cumsum(u_ext.astype(jnp.float32), axis=1)
    csum = jnp.pad(csum, ((0, 0), (1, 0), (0, 0)))
    hi = csum[:, POOL_PAD + 1:POOL_PAD + 1 + n]
    pos = pos0 + jnp.arange(n)
    outs = []
    for g, w in enumerate(POOL_WINDOWS):
        cs = slice(g * POOL_GROUP_DIM, (g + 1) * POOL_GROUP_DIM)
        win_sum = hi[..., cs] - csum[:, POOL_PAD + 1 - w:POOL_PAD + 1 - w + n, cs]
        count = jnp.minimum(pos + 1, w).astype(jnp.float32)[None, :, None]
        pooled = win_sum / count - u[..., cs].astype(jnp.float32)
        outs.append(jnp.einsum('bnc,ce->bne', pooled.astype(u.dtype), w_grp[g]))
    z = jnp.concatenate(outs, axis=-1) * scale
    return z @ w_out, u_ext[:, -POOL_PAD:]


def dilated_group_attention(q, k, v, q_off, dilation, n_keys, bias):
    steps = jnp.arange(n_keys) * dilation

    def attend(q_blk, rows):
        idx = rows[:, None] - steps[None, :]
        valid = idx >= 0
        idx = jnp.maximum(idx, 0)
        kg = jnp.take(k, idx, axis=1, mode='clip')
        vg = jnp.take(v, idx, axis=1, mode='clip')
        s = jnp.einsum('bqhd,bqkhd->bhqk', q_blk, kg).astype(jnp.float32)
        s = s + bias.astype(jnp.float32)[None, :, None, :]
        s = jnp.where(valid[None, None], s, NEG)
        lse = jax.nn.logsumexp(s, axis=-1)
        p = jnp.exp(s - lse[..., None])
        o = jnp.einsum('bhqk,bqkhd->bqhd', p.astype(vg.dtype), vg)
        return o, jnp.transpose(lse, (0, 2, 1))

    b, nq, h, d = q.shape
    rows = q_off + jnp.arange(nq)
    if nq > Q_BLOCK and nq % Q_BLOCK == 0:
        nb = nq // Q_BLOCK
        qb = q.reshape(b, nb, Q_BLOCK, h, d).swapaxes(0, 1)
        rb = rows.reshape(nb, Q_BLOCK)
        o, lse = lax.map(lambda a: attend(a[0], a[1]), (qb, rb))
        o = o.swapaxes(0, 1).reshape(b, nq, h, d)
        lse = lse.swapaxes(0, 1).reshape(b, nq, h)
    else:
        o, lse = attend(q, rows)
    return o, lse


def dilated_mixer(x, kv_groups, q_offs, w_q, w_o, rel_bias):
    b, n, _ = x.shape
    q = (x @ w_q).reshape(b, n, N_DIL_GROUPS, HEADS_PER_GROUP, HEAD_DIM) * (HEAD_DIM ** -0.5)
    outs, lses = [], []
    for g, (win, dil) in enumerate(DIL_PATTERNS):
        n_keys = win // dil + 1
        buckets = t5_buckets(np.arange(n_keys) * dil)
        bias = rel_bias[buckets][:, g * HEADS_PER_GROUP:(g + 1) * HEADS_PER_GROUP].T
        k, v = kv_groups[g]
        o, lse = dilated_group_attention(q[:, :, g], k, v, q_offs[g], dil, n_keys, bias)
        outs.append(o)
        lses.append(lse)
    wts = jax.nn.softmax(jnp.stack(lses), axis=0)
    o = jnp.sum(jnp.stack(outs).astype(jnp.float32) * wts[..., None], axis=0).astype(x.dtype)
    return o.reshape(b, n, ATTN_GROUP_WIDTH) @ w_o


def trunk(x, pool_prefix, kv_past, pos0, ln_g, ln_b, ffn_w13, ffn_w2, pool_w_in, pool_w_grp, pool_scale,
          pool_w_out, attn_w_kv, attn_w_q, attn_w_o, rel_bias):
    pool_states = []
    kv_new = None
    kv_groups, q_offs = [], []
    for layer in range(DEPTH):
        if layer == N_A_LAYERS:
            b, n, _ = x.shape
            kv_new = (x @ attn_w_kv).reshape(b, n, N_DIL_GROUPS, 2, HEADS_PER_GROUP, HEAD_DIM)
            for g in range(N_DIL_GROUPS):
                if kv_past is None:
                    kv_g, off = kv_new[:, :, g], 0
                else:
                    kv_g = jnp.concatenate([kv_past[g].astype(kv_new.dtype), kv_new[:, :, g]], axis=1)
                    off = kv_past[g].shape[1]
                kv_groups.append((kv_g[:, :, 0], kv_g[:, :, 1]))
                q_offs.append(off)
        x = layer_norm(ALPHA * x + 0.5 * swiglu(x, ffn_w13[layer, 0], ffn_w2[layer, 0]), ln_g[layer, 0], ln_b[layer, 0])
        if layer < N_A_LAYERS:
            mix, st = pool_mixer(x, pool_prefix[layer], pos0, pool_w_in[layer], pool_w_grp[layer],
                                 pool_scale[layer], pool_w_out[layer])
            pool_states.append(st)
        else:
            j = layer - N_A_LAYERS
            mix = dilated_mixer(x, kv_groups, q_offs, attn_w_q[j], attn_w_o[j], rel_bias)
        x = layer_norm(ALPHA * x + mix, ln_g[layer, 1], ln_b[layer, 1])
        x = layer_norm(ALPHA * x + 0.5 * swiglu(x, ffn_w13[layer, 1], ffn_w2[layer, 1]), ln_g[layer, 2], ln_b[layer, 2])
    return x, jnp.stack(pool_states), kv_new


def setup_inputs(seed: int = 0) -> dict:
    key = jax.random.key(seed)
    ks = jax.random.split(key, 20)

    def nrm(k, shape, scale):
        return jax.random.normal(k, shape, jnp.float32) * scale

    x_prompt = nrm(ks[0], (BATCH, SEQ, D_MODEL), 1.0)
    x_sample = nrm(ks[1], (DEC_BATCH, DEC_SEQ, D_MODEL), 1.0)
    state_pool = nrm(ks[2], (N_A_LAYERS, DEC_BATCH, POOL_PAD, D_MODEL), 1.0)
    caches = [nrm(ks[3 + g], (DEC_BATCH, min(w, PAST_LEN), 2, HEADS_PER_GROUP, HEAD_DIM), 1.0)
              for g, (w, _) in enumerate(DIL_PATTERNS)]
    ln_g = 1.0 + nrm(ks[6], (DEPTH, 3, D_MODEL), 0.05)
    ln_b = nrm(ks[7], (DEPTH, 3, D_MODEL), 0.02)
    ffn_w13 = nrm(ks[8], (DEPTH, 2, D_MODEL, 2 * D_FF), D_MODEL ** -0.5)
    ffn_w2 = nrm(ks[9], (DEPTH, 2, D_FF, D_MODEL), (D_FF ** -0.5) * BETA)
    pool_w_in = nrm(ks[10], (N_A_LAYERS, D_MODEL, D_MODEL), D_MODEL ** -0.5)
    pool_w_grp = nrm(ks[11], (N_A_LAYERS, POOL_GROUPS, POOL_GROUP_DIM, POOL_GROUP_DIM), POOL_GROUP_DIM ** -0.5)
    pool_scale = 1.0 + nrm(ks[12], (N_A_LAYERS, D_MODEL), 0.1)
    pool_w_out = nrm(ks[13], (N_A_LAYERS, D_MODEL, D_MODEL), (D_MODEL ** -0.5) * BETA)
    kv_scale = jnp.array([1.0, BETA], jnp.float32)[None, None, :, None]
    attn_w_kv = (nrm(ks[14], (D_MODEL, N_DIL_GROUPS, 2, ATTN_GROUP_WIDTH), D_MODEL ** -0.5) * kv_scale).reshape(D_MODEL, KV_WIDTH)
    attn_w_q = nrm(ks[15], (N_B_LAYERS, D_MODEL, Q_WIDTH), D_MODEL ** -0.5)
    attn_w_o = nrm(ks[16], (N_B_LAYERS, ATTN_GROUP_WIDTH, D_MODEL), (ATTN_GROUP_WIDTH ** -0.5) * BETA)
    rel_bias = nrm(ks[17], (N_BUCKETS, N_HEADS), 0.3)
    return {'x_prompt': x_prompt, 'x_sample': x_sample, 'state_pool': state_pool,
            'cache_kv_w128': caches[0], 'cache_kv_w512': caches[1], 'cache_kv_w2048': caches[2],
            'ln_g': ln_g, 'ln_b': ln_b, 'ffn_w13': ffn_w13, 'ffn_w2': ffn_w2,
            'pool_w_in': pool_w_in, 'pool_w_grp': pool_w_grp, 'pool_scale': pool_scale, 'pool_w_out': pool_w_out,
            'attn_w_kv': attn_w_kv, 'attn_w_q': attn_w_q, 'attn_w_o': attn_w_o, 'rel_bias': rel_bias}


def reference(x_prompt, x_sample, state_pool, cache_kv_w128, cache_kv_w512, cache_kv_w2048, ln_g, ln_b, ffn_w13,
              ffn_w2, pool_w_in, pool_w_grp, pool_scale, pool_w_out, attn_w_kv, attn_w_q, attn_w_o, rel_bias):
    weights = (ln_g, ln_b, ffn_w13, ffn_w2, pool_w_in, pool_w_grp, pool_scale, pool_w_out,
               attn_w_kv, attn_w_q, attn_w_o, rel_bias)
    pool_zero = jnp.zeros((N_A_LAYERS, x_prompt.shape[0], POOL_PAD, D_MODEL), x_prompt.dtype)
    y_prompt, pool_p, kv_p = trunk(x_prompt, pool_zero, None, 0, *weights)
    y_sample, pool_s, kv_s = trunk(x_sample, state_pool, (cache_kv_w128, cache_kv_w512, cache_kv_w2048),
                                   PAST_LEN, *weights)
    n = x_prompt.shape[1]
    kv_p_groups = [kv_p[:, n - min(w, n):, g] for g, (w, _) in enumerate(DIL_PATTERNS)]
    return (y_prompt, y_sample, pool_p, pool_s, kv_p_groups[0], kv_p_groups[1], kv_p_groups[2],
            kv_s[:, :, 0], kv_s[:, :, 1], kv_s[:, :, 2])
```

```cpp
#include <hip/hip_runtime.h>
#include <cstdio>
#include <cmath>
namespace nv {
constexpr int D = 1024, DFF = 2816, QW = 1536, KVW = 3072, AGW = 512;
constexpr float ALPHA = 1.41421356237f, EPS = 1e-5f;
__device__ const unsigned char BUCKET[3][129] = {
{0,1,2,3,4,5,6,7,8,9,10,11,12,13,14,15,16,16,16,16,16,16,17,17,17,17,17,17,17,17,18,18,18,18,18,18,18,18,18,18,19,19,19,19,19,19,19,19,19,19,19,19,19,19,20,20,20,20,20,20,20,20,20,20,20,20,20,20,20,20,20,20,20,21,21,21,21,21,21,21,21,21,21,21,21,21,21,21,21,21,21,21,21,21,21,21,21,21,21,22,22,22,22,22,22,22,22,22,22,22,22,22,22,22,22,22,22,22,22,22,22,22,22,22,22,22,22,22,22},
{0,4,8,12,16,16,17,17,18,18,19,19,19,19,20,20,20,20,20,21,21,21,21,21,21,22,22,22,22,22,22,22,22,22,23,23,23,23,23,23,23,23,23,23,23,23,24,24,24,24,24,24,24,24,24,24,24,24,24,24,24,24,25,25,25,25,25,25,25,25,25,25,25,25,25,25,25,25,25,25,25,25,25,26,26,26,26,26,26,26,26,26,26,26,26,26,26,26,26,26,26,26,26,26,26,26,26,26,26,26,26,26,26,27,27,27,27,27,27,27,27,27,27,27,27,27,27,27,27},
{0,16,18,19,20,21,21,22,22,23,23,23,24,24,24,24,25,25,25,25,25,26,26,26,26,26,26,26,26,27,27,27,27,27,27,27,27,27,27,28,28,28,28,28,28,28,28,28,28,28,28,28,29,29,29,29,29,29,29,29,29,29,29,29,29,29,29,29,29,29,30,30,30,30,30,30,30,30,30,30,30,30,30,30,30,30,30,30,30,30,30,30,30,30,30,31,31,31,31,31,31,31,31,31,31,31,31,31,31,31,31,31,31,31,31,31,31,31,31,31,31,31,31,31,31,31,31,31,31}};

__global__ void __launch_bounds__(256) sgemm(const float* __restrict__ A, int lda, const float* __restrict__ B, int ldb, float* __restrict__ C, int ldc, int K) {
    __shared__ float As[16][64 + 4], Bs[16][64 + 4];
    const int t = threadIdx.x, tx = t & 15, ty = t >> 4;
    const int m0 = blockIdx.y * 64, n0 = blockIdx.x * 64;
    float acc[4][4] = {};
    for (int k0 = 0; k0 < K; k0 += 16) {
        { const int r = t >> 2, kq = (t & 3) * 4; const float4 a = *(const float4*)(A + (size_t)(m0 + r) * lda + k0 + kq);
          As[kq + 0][r] = a.x; As[kq + 1][r] = a.y; As[kq + 2][r] = a.z; As[kq + 3][r] = a.w; }
        { const int r = t >> 4, c = (t & 15) * 4; const float4 b = *(const float4*)(B + (size_t)(k0 + r) * ldb + n0 + c);
          Bs[r][c + 0] = b.x; Bs[r][c + 1] = b.y; Bs[r][c + 2] = b.z; Bs[r][c + 3] = b.w; }
        __syncthreads();
#pragma unroll
        for (int k = 0; k < 16; ++k) {
            float a[4], b[4];
#pragma unroll
            for (int i = 0; i < 4; ++i) { a[i] = As[k][ty * 4 + i]; b[i] = Bs[k][tx * 4 + i]; }
#pragma unroll
            for (int i = 0; i < 4; ++i)
#pragma unroll
                for (int j = 0; j < 4; ++j) acc[i][j] += a[i] * b[j];
        }
        __syncthreads();
    }
#pragma unroll
    for (int i = 0; i < 4; ++i) *(float4*)(C + (size_t)(m0 + ty * 4 + i) * ldc + n0 + tx * 4) = make_float4(acc[i][0], acc[i][1], acc[i][2], acc[i][3]);
}
__global__ void ffn_act(const float* __restrict__ T1, float* __restrict__ H, int M) {
    const size_t n = (size_t)M * DFF;
    for (size_t i = (size_t)blockIdx.x * blockDim.x + threadIdx.x; i < n; i += (size_t)gridDim.x * blockDim.x) {
        const size_t r = i / DFF; const int j = (int)(i % DFF);
        const float g = T1[r * (2 * DFF) + j], u = T1[r * (2 * DFF) + DFF + j];
        H[i] = g / (1.f + expf(-g)) * u;
    }
}
__global__ void __launch_bounds__(256) res_ln(const float* X, const float* __restrict__ Y, float s, const float* __restrict__ g, const float* __restrict__ b, float* Xout) {
    __shared__ float red[8];
    const size_t row = blockIdx.x; const int t = threadIdx.x;
    float4 x = *(const float4*)(X + row * D + t * 4); const float4 y = *(const float4*)(Y + row * D + t * 4);
    float v[4] = {ALPHA * x.x + s * y.x, ALPHA * x.y + s * y.y, ALPHA * x.z + s * y.z, ALPHA * x.w + s * y.w};
    float sum = v[0] + v[1] + v[2] + v[3];
    for (int o = 32; o >= 1; o >>= 1) sum += __shfl_xor(sum, o);
    if ((t & 63) == 0) red[t >> 6] = sum;
    __syncthreads();
    const float mean = (red[0] + red[1] + red[2] + red[3]) * (1.f / D);
    float q = 0.f;
#pragma unroll
    for (int i = 0; i < 4; ++i) { v[i] -= mean; q += v[i] * v[i]; }
    for (int o = 32; o >= 1; o >>= 1) q += __shfl_xor(q, o);
    if ((t & 63) == 0) red[4 + (t >> 6)] = q;
    __syncthreads();
    const float rstd = 1.f / sqrtf((red[4] + red[5] + red[6] + red[7]) * (1.f / D) + EPS);
    const float4 gg = *(const float4*)(g + t * 4), bb = *(const float4*)(b + t * 4);
    *(float4*)(Xout + row * D + t * 4) = make_float4(v[0] * rstd * gg.x + bb.x, v[1] * rstd * gg.y + bb.y, v[2] * rstd * gg.z + bb.z, v[3] * rstd * gg.w + bb.w);
}
__global__ void pool(const float* __restrict__ U, const float* __restrict__ prefix, float* __restrict__ PL, int B, int N, int pos0) {
    const size_t tot = (size_t)B * N * D;
    for (size_t i = (size_t)blockIdx.x * blockDim.x + threadIdx.x; i < tot; i += (size_t)gridDim.x * blockDim.x) {
        const int c = (int)(i % D); const size_t rn = i / D; const int n = (int)(rn % N), b = (int)(rn / N);
        const int w = 2 << (c >> 8);
        float s = 0.f;
        for (int j = 0; j < w; ++j) { const int idx = n - j;
            if (idx >= 0) s += U[((size_t)b * N + idx) * D + c];
            else if (prefix) s += prefix[((size_t)b * 15 + 15 + idx) * D + c]; }
        const int pos = pos0 + n; const float cnt = (float)((pos + 1 < w) ? pos + 1 : w);
        PL[i] = s / cnt - U[i];
    }
}
__global__ void col_scale(float* Z, const float* __restrict__ sc, size_t M) {
    const size_t tot = M * D;
    for (size_t i = (size_t)blockIdx.x * blockDim.x + threadIdx.x; i < tot; i += (size_t)gridDim.x * blockDim.x) Z[i] *= sc[i % D];
}
__global__ void pool_state(const float* __restrict__ U, const float* __restrict__ prefix, float* __restrict__ out, int B, int N) {
    const size_t tot = (size_t)B * 15 * D;
    for (size_t i = (size_t)blockIdx.x * blockDim.x + threadIdx.x; i < tot; i += (size_t)gridDim.x * blockDim.x) {
        const int c = (int)(i % D); const int r = (int)((i / D) % 15), b = (int)(i / D / 15);
        const int e = N + r;
        float v;
        if (e >= 15) v = U[((size_t)b * N + (e - 15)) * D + c]; else v = prefix ? prefix[((size_t)b * 15 + e) * D + c] : 0.f;
        out[i] = v;
    }
}
__global__ void kv_out(const float* __restrict__ KV, float* __restrict__ out, int B, int N, int W, int g) {
    const size_t tot = (size_t)B * W * 1024;
    for (size_t i = (size_t)blockIdx.x * blockDim.x + threadIdx.x; i < tot; i += (size_t)gridDim.x * blockDim.x) {
        const int c = (int)(i % 1024); const int r = (int)((i / 1024) % W), b = (int)(i / 1024 / W);
        out[i] = KV[((size_t)b * N + (N - W + r)) * KVW + g * 1024 + c];
    }
}
__global__ void __launch_bounds__(256) attn(const float* __restrict__ Q, const float* __restrict__ KVn, const float* __restrict__ c0, const float* __restrict__ c1, const float* __restrict__ c2,
                                            const float* __restrict__ rel_bias, float* __restrict__ O, int B, int N) {
    const int wave = (int)((blockIdx.x * (size_t)blockDim.x + threadIdx.x) >> 6), lane = threadIdx.x & 63;
    if (wave >= B * N * 8) return;
    const int h = wave & 7, n = (wave >> 3) % N, b = (wave >> 3) / N;
    float og[3], lse[3];
    for (int g = 0; g < 3; ++g) {
        const int dil = (g == 0) ? 1 : (g == 1 ? 4 : 16), W = 128 * dil;
        const float* cache = (g == 0) ? c0 : (g == 1 ? c1 : c2);
        const int qoff = cache ? W : 0;
        const float q = Q[((size_t)b * N + n) * QW + g * 512 + h * 64 + lane] * 0.125f;
        float m = -INFINITY, l = 0.f, acc = 0.f;
        for (int j = 0; j <= 128; ++j) {
            const int idx = qoff + n - j * dil;
            if (idx < 0) break;
            const float *kp, *vp;
            if (cache && idx < W) { kp = cache + (((size_t)b * W + idx) * 2 + 0) * 512 + h * 64; vp = kp + 512; }
            else { const int r = idx - qoff; kp = KVn + ((size_t)b * N + r) * KVW + g * 1024 + h * 64; vp = kp + 512; }
            float s = q * kp[lane];
            for (int o = 32; o >= 1; o >>= 1) s += __shfl_xor(s, o);
            s += rel_bias[BUCKET[g][j] * 24 + g * 8 + h];
            const float mn = fmaxf(m, s), f = expf(m - mn), p = expf(s - mn);
            l = l * f + p; acc = acc * f + p * vp[lane]; m = mn;
        }
        og[g] = acc / l; lse[g] = m + logf(l);
    }
    const float mx = fmaxf(lse[0], fmaxf(lse[1], lse[2]));
    const float w0 = expf(lse[0] - mx), w1 = expf(lse[1] - mx), w2 = expf(lse[2] - mx);
    O[((size_t)b * N + n) * AGW + h * 64 + lane] = (w0 * og[0] + w1 * og[1] + w2 * og[2]) / (w0 + w1 + w2);
}
__global__ void copy_f32(const float* __restrict__ s, float* __restrict__ d, size_t n) {
    for (size_t i = (size_t)blockIdx.x * blockDim.x + threadIdx.x; i < n; i += (size_t)gridDim.x * blockDim.x) d[i] = s[i];
}

struct In { const float *xp, *xs, *state, *c128, *c512, *c2048, *ln_g, *ln_b, *w13, *w2, *w_in, *w_grp, *pscale, *w_out, *w_kv, *w_q, *w_o, *relb; };
struct Out { float *yp, *ys, *psp, *pss, *kp[3], *ks[3]; };

inline void gemm(hipStream_t st, const float* A, int lda, const float* B, int ldb, float* C, int ldc, int M, int N, int K) {
    sgemm<<<dim3(N / 64, M / 64), 256, 0, st>>>(A, lda, B, ldb, C, ldc, K);
}
inline void trunk(hipStream_t st, const In& I, const float* x_in, int B, int N, const float* prefix, const float* c0, const float* c1, const float* c2, int pos0,
                  float* y_out, float* ps_out, float* const* kv_outs, float* ws) {
    const int M = B * N; const int Mc = M < 4096 ? M : 4096;
    float* X = ws; ws += (size_t)M * D;
    float* Y = ws; ws += (size_t)M * D;
    float* U = ws; ws += (size_t)M * D;
    float* PL = ws; ws += (size_t)M * D;
    float* KV = ws; ws += (size_t)M * KVW;
    float* Qb = ws; ws += (size_t)M * QW;
    float* Ob = ws; ws += (size_t)M * AGW;
    float* T1 = ws; ws += (size_t)Mc * 2 * DFF;
    float* Hh = ws; ws += (size_t)Mc * DFF;
    copy_f32<<<2048, 256, 0, st>>>(x_in, X, (size_t)M * D);
    auto ffn = [&](int layer, int which, int lnidx) {
        const float* w13 = I.w13 + (size_t)(layer * 2 + which) * D * 2 * DFF; const float* w2 = I.w2 + (size_t)(layer * 2 + which) * DFF * D;
        for (int m0 = 0; m0 < M; m0 += Mc) {
            gemm(st, X + (size_t)m0 * D, D, w13, 2 * DFF, T1, 2 * DFF, Mc, 2 * DFF, D);
            ffn_act<<<2048, 256, 0, st>>>(T1, Hh, Mc);
            gemm(st, Hh, DFF, w2, D, Y + (size_t)m0 * D, D, Mc, D, DFF);
        }
        res_ln<<<M, 256, 0, st>>>(X, Y, 0.5f, I.ln_g + (layer * 3 + lnidx) * D, I.ln_b + (layer * 3 + lnidx) * D, X);
    };
    ffn(0, 0, 0);
    gemm(st, X, D, I.w_in, D, U, D, M, D, D);
    pool_state<<<256, 256, 0, st>>>(U, prefix, ps_out, B, N);
    pool<<<4096, 256, 0, st>>>(U, prefix, PL, B, N, pos0);
    for (int g = 0; g < 4; ++g) gemm(st, PL + g * 256, D, I.w_grp + (size_t)g * 65536, 256, U + g * 256, D, M, 256, 256);
    col_scale<<<2048, 256, 0, st>>>(U, I.pscale, (size_t)M);
    gemm(st, U, D, I.w_out, D, Y, D, M, D, D);
    res_ln<<<M, 256, 0, st>>>(X, Y, 1.0f, I.ln_g + (0 * 3 + 1) * D, I.ln_b + (0 * 3 + 1) * D, X);
    ffn(0, 1, 2);
    gemm(st, X, D, I.w_kv, KVW, KV, KVW, M, KVW, D);
    for (int g = 0; g < 3; ++g) { const int W0 = 128 << (2 * g); const int W = W0 < N ? W0 : N; kv_out<<<1024, 256, 0, st>>>(KV, kv_outs[g], B, N, W, g); }
    ffn(1, 0, 0);
    gemm(st, X, D, I.w_q, QW, Qb, QW, M, QW, D);
    attn<<<(M * 8 * 64 + 255) / 256, 256, 0, st>>>(Qb, KV, c0, c1, c2, I.relb, Ob, B, N);
    gemm(st, Ob, AGW, I.w_o, D, Y, D, M, D, AGW);
    res_ln<<<M, 256, 0, st>>>(X, Y, 1.0f, I.ln_g + (1 * 3 + 1) * D, I.ln_b + (1 * 3 + 1) * D, X);
    ffn(1, 1, 2);
    copy_f32<<<2048, 256, 0, st>>>(X, y_out, (size_t)M * D);
}
inline void forward(hipStream_t st, void* const* d_in, float* d_out, float* ws) {
    In I{(const float*)d_in[0], (const float*)d_in[1], (const float*)d_in[2], (const float*)d_in[3], (const float*)d_in[4], (const float*)d_in[5], (const float*)d_in[6], (const float*)d_in[7],
         (const float*)d_in[8], (const float*)d_in[9], (const float*)d_in[10], (const float*)d_in[11], (const float*)d_in[12], (const float*)d_in[13], (const float*)d_in[14], (const float*)d_in[15],
         (const float*)d_in[16], (const float*)d_in[17]};
    Out o; float* p = d_out;
    o.yp = p; p += (size_t)4 * 4096 * 1024; o.ys = p; p += 32 * 4 * 1024; o.psp = p; p += 4 * 15 * 1024; o.pss = p; p += 32 * 15 * 1024;
    o.kp[0] = p; p += 4 * 128 * 1024; o.kp[1] = p; p += 4 * 512 * 1024; o.kp[2] = p; p += (size_t)4 * 2048 * 1024;
    o.ks[0] = p; p += 32 * 4 * 1024; o.ks[1] = p; p += 32 * 4 * 1024; o.ks[2] = p; p += 32 * 4 * 1024;
    trunk(st, I, I.xp, 4, 4096, nullptr, nullptr, nullptr, nullptr, 0, o.yp, o.psp, o.kp, ws);
    trunk(st, I, I.xs, 32, 4, I.state, I.c128, I.c512, I.c2048, 16384, o.ys, o.pss, o.ks, ws);
}
}
extern "C" void kernel_launch(void* const* d_in, const int* in_sizes, int n_in,
                              void* d_out, int out_size, void* d_ws, size_t ws_size,
                              hipStream_t stream) {
    if (ws_size < (size_t)760 * 1024 * 1024) { fprintf(stderr, "ws too small: %zu\n", ws_size); return; }
    nv::forward(stream, d_in, (float*)d_out, (float*)d_ws);
}
```

```cpp
#include <hip/hip_runtime.h>
#include <hip/hip_cooperative_groups.h>
#include <cstdio>
#include <cmath>
#define HYB_STAGE 6
namespace mk {
#define LAS __attribute__((address_space(3)))
typedef unsigned short bf16_t;
typedef short bf16x8 __attribute__((ext_vector_type(8)));
typedef float f32x4 __attribute__((ext_vector_type(4)));
typedef float f32x16 __attribute__((ext_vector_type(16)));
typedef unsigned u32x4 __attribute__((ext_vector_type(4)));
typedef unsigned u32x2 __attribute__((ext_vector_type(2)));

constexpr int D = 1024, DFF = 2816, NTOK = 16384, NS = 128, MP = 16640;
constexpr float ALPHA = 1.41421356237f, LN_EPS = 1e-5f;
constexpr float LOG2E = 1.4426950408889634f, LN2 = 0.6931471805599453f;
constexpr float QSCALE = 0.125f * LOG2E;
constexpr int NWAVES = 8, NTHREADS = 512;

constexpr size_t O_YP = 0, O_YS = 16777216, O_PSP = O_YS + 131072, O_PSS = O_PSP + 61440, O_KP0 = O_PSS + 491520, O_KP1 = O_KP0 + 524288,
                 O_KP2 = O_KP1 + 2097152, O_KS0 = O_KP2 + 8388608, O_KS1 = O_KS0 + 131072, O_KS2 = O_KS1 + 131072, O_END = O_KS2 + 131072;
constexpr size_t MiB = 1u << 20;
constexpr size_t WS_CTL = 0, CTL_BYTES = 1 * MiB;
constexpr size_t W13_BYTES = (size_t)5632 * 1024 * 2, W2_BYTES = (size_t)1024 * 2816 * 2;
constexpr size_t WS_W13 = 2 * MiB, WS_W2 = 46 * MiB, WS_WIN = 68 * MiB, WS_WGRP = 70 * MiB, WS_WOUT = 71 * MiB, WS_WKV = 73 * MiB, WS_WQ = 79 * MiB, WS_WO = 82 * MiB;
constexpr size_t WS_X = 84 * MiB, WS_Y = 149 * MiB, WS_XN = 214 * MiB, WS_H = 247 * MiB, WS_U = 337 * MiB, WS_PL = 370 * MiB, WS_Z = 403 * MiB;
constexpr size_t WS_KB = 436 * MiB, WS_VT = 485 * MiB, WS_QB = 534 * MiB, WS_OG = 583 * MiB, WS_LSE = 632 * MiB, WS_O = 634 * MiB, WS_END = 652 * MiB;
constexpr size_t GRP_BYTES = (size_t)MP * 512 * 2;
constexpr size_t LSE_BYTES = (size_t)MP * 8 * 4;
static_assert(WS_W13 + 4 * W13_BYTES <= WS_W2 && WS_W2 + 4 * W2_BYTES <= WS_WIN && WS_X + (size_t)MP * D * 4 <= WS_Y && WS_Y + (size_t)MP * D * 4 <= WS_XN &&
              WS_XN + (size_t)MP * D * 2 <= WS_H && WS_H + (size_t)MP * DFF * 2 <= WS_U && WS_U + (size_t)MP * D * 2 <= WS_PL && WS_Z + (size_t)MP * D * 2 <= WS_KB &&
              WS_KB + 3 * GRP_BYTES <= WS_VT && WS_VT + 3 * GRP_BYTES <= WS_QB && WS_QB + 3 * GRP_BYTES <= WS_OG && WS_OG + 3 * GRP_BYTES <= WS_LSE && WS_LSE + 3 * LSE_BYTES <= WS_O &&
              WS_O + GRP_BYTES <= WS_END, "ws map");
constexpr int LDS_BYTES = 147456;

struct Params { const float* in[18]; float* out; unsigned char* ws; int ph_lo, ph_hi; };

__device__ const unsigned char BUCKET[3][129] = {
{0,1,2,3,4,5,6,7,8,9,10,11,12,13,14,15,16,16,16,16,16,16,17,17,17,17,17,17,17,17,18,18,18,18,18,18,18,18,18,18,19,19,19,19,19,19,19,19,19,19,19,19,19,19,20,20,20,20,20,20,20,20,20,20,20,20,20,20,20,20,20,20,20,21,21,21,21,21,21,21,21,21,21,21,21,21,21,21,21,21,21,21,21,21,21,21,21,21,21,22,22,22,22,22,22,22,22,22,22,22,22,22,22,22,22,22,22,22,22,22,22,22,22,22,22,22,22,22,22},
{0,4,8,12,16,16,17,17,18,18,19,19,19,19,20,20,20,20,20,21,21,21,21,21,21,22,22,22,22,22,22,22,22,22,23,23,23,23,23,23,23,23,23,23,23,23,24,24,24,24,24,24,24,24,24,24,24,24,24,24,24,24,25,25,25,25,25,25,25,25,25,25,25,25,25,25,25,25,25,25,25,25,25,26,26,26,26,26,26,26,26,26,26,26,26,26,26,26,26,26,26,26,26,26,26,26,26,26,26,26,26,26,26,27,27,27,27,27,27,27,27,27,27,27,27,27,27,27,27},
{0,16,18,19,20,21,21,22,22,23,23,23,24,24,24,24,25,25,25,25,25,26,26,26,26,26,26,26,26,27,27,27,27,27,27,27,27,27,27,28,28,28,28,28,28,28,28,28,28,28,28,28,29,29,29,29,29,29,29,29,29,29,29,29,29,29,29,29,29,29,30,30,30,30,30,30,30,30,30,30,30,30,30,30,30,30,30,30,30,30,30,30,30,30,30,31,31,31,31,31,31,31,31,31,31,31,31,31,31,31,31,31,31,31,31,31,31,31,31,31,31,31,31,31,31,31,31,31,31}};

__device__ __forceinline__ unsigned f2bf(float f) { unsigned u = __float_as_uint(f); return (u + 0x7fffu + ((u >> 16) & 1u)) >> 16; }
__device__ __forceinline__ unsigned pk2(float lo, float hi) { return f2bf(lo) | (f2bf(hi) << 16); }
__device__ __forceinline__ unsigned cvt_pk_bf16(float lo, float hi) { unsigned r; asm volatile("v_cvt_pk_bf16_f32 %0, %1, %2" : "=v"(r) : "v"(lo), "v"(hi)); return r; }
__device__ __forceinline__ float bf_lo(unsigned w) { return __uint_as_float(w << 16); }
__device__ __forceinline__ float bf_hi(unsigned w) { return __uint_as_float(w & 0xffff0000u); }
__device__ __forceinline__ float wave_sum(float v) {
#pragma unroll
    for (int o = 1; o < 64; o <<= 1) v += __shfl_xor(v, o);
    return v;
}

constexpr int BM = 256, BK = 64, HALF = 128, HTB = HALF * BK * 2, STAGE_BYTES = 8 * HTB;
__device__ __forceinline__ int lds_byte(int r, int c) { const int st = (r >> 4) * 2 + (c >> 5), rr = r & 15, cc = c & 31, ob = rr * 64 + cc * 2; return st * 1024 + (ob ^ (((ob >> 9) & 1) << 5)); }
__device__ __forceinline__ void stage_rc(int b, int& R, int& C) { const int st = b / 1024, sb = b % 1024, swz = sb ^ (((sb >> 9) & 1) << 5); R = (st >> 1) * 16 + swz / 64; C = (st & 1) * 32 + (swz % 64) / 2; }
__device__ __forceinline__ int perm32(int rho) { const int n = rho >> 4, i = rho & 15; return 8 * (i >> 2) + 4 * n + (i & 3); }

struct UnitD { const char* a0; const char* a1; const char* b0; const char* b1; unsigned sa, sb; int kind, x0, x1, x2; };
enum { KIND_G1 = 0, KIND_Y = 1, KIND_U = 2, KIND_Z = 3, KIND_K = 4, KIND_VT = 5, KIND_Q = 6 };

__device__ __forceinline__ void tile_of(int L, int nM, int nN, int& pm, int& pn) {
    const int nwg = nM * nN, q = nwg / 8, r = nwg % 8, xcd = L % 8, off = L / 8;
    const int w = (xcd < r ? xcd * (q + 1) : r * (q + 1) + (xcd - r) * q) + off;
    const int nig = 8 * nN, gid = w / nig, fm = gid * 8, gsz = (nM - fm) < 8 ? (nM - fm) : 8;
    pm = fm + ((w % nig) % gsz); pn = (w % nig) / gsz;
}
__device__ __forceinline__ void dil_tile(int g, int T, int& row0, int& step) {
    if (T >= 64) { row0 = NTOK; step = 1; return; }
    const int sh = 2 * g, b = T >> 4, i = (T & 15) * 256, Lg = 4096 >> sh, r = i / Lg, t0 = i % Lg;
    row0 = b * 4096 + r + (t0 << sh); step = 1 << sh;
}

enum { PH_G1 = 0, PH_G2, PH_WIN, PH_Z, PH_WOUT, PH_KVG1, PH_Q, PH_WO };
struct PhaseSched {
    int ph, G, c, wsel; const unsigned char* ws;
    __device__ __forceinline__ int depth() const { return ph == PH_G2 ? DFF : (ph == PH_Z ? 256 : (ph == PH_WO ? 512 : D)); }
    __device__ __forceinline__ void fill_g1(int L, UnitD& u) const {
        int pm, pn; tile_of(L, 65, 22, pm, pn);
        u.a0 = (const char*)ws + WS_XN + (size_t)pm * 256 * 2048; u.a1 = u.a0 + 128 * 2048; u.sa = 2048;
        u.b0 = (const char*)ws + WS_W13 + (size_t)wsel * W13_BYTES + (size_t)pn * 256 * 2048; u.b1 = u.b0 + 128 * 2048; u.sb = 2048;
        u.kind = KIND_G1; u.x0 = pm; u.x1 = pn; u.x2 = 0;
    }
    __device__ __forceinline__ bool next(int i, UnitD& u) const {
        const long Ll = (long)i * G + c;
        switch (ph) {
        case PH_G1: { if (Ll >= 65 * 22) return false; fill_g1((int)Ll, u); return true; }
        case PH_G2: { if (Ll >= 64 * 4) return false; int pm, pn; tile_of((int)Ll, 64, 4, pm, pn);
            u.a0 = (const char*)ws + WS_H + (size_t)pm * 256 * 5632; u.a1 = u.a0 + 128 * 5632; u.sa = 5632;
            u.b0 = (const char*)ws + WS_W2 + (size_t)wsel * W2_BYTES + (size_t)pn * 256 * 5632; u.b1 = u.b0 + 128 * 5632; u.sb = 5632;
            u.kind = KIND_Y; u.x0 = pm; u.x1 = pn; u.x2 = __float_as_int(0.5f); return true; }
        case PH_WIN: { if (Ll >= 64 * 4) return false; int pm, pn; tile_of((int)Ll, 64, 4, pm, pn);
            u.a0 = (const char*)ws + WS_XN + (size_t)pm * 256 * 2048; u.a1 = u.a0 + 128 * 2048; u.sa = 2048;
            u.b0 = (const char*)ws + WS_WIN + (size_t)pn * 256 * 2048; u.b1 = u.b0 + 128 * 2048; u.sb = 2048;
            u.kind = KIND_U; u.x0 = pm; u.x1 = pn; u.x2 = 0; return true; }
        case PH_Z: { if (Ll >= 64 * 4) return false; int pm, pn; tile_of((int)Ll, 64, 4, pm, pn);
            u.a0 = (const char*)ws + WS_PL + (size_t)pm * 256 * 2048 + (size_t)pn * 512; u.a1 = u.a0 + 128 * 2048; u.sa = 2048;
            u.b0 = (const char*)ws + WS_WGRP + (size_t)pn * 256 * 512; u.b1 = u.b0 + 128 * 512; u.sb = 512;
            u.kind = KIND_Z; u.x0 = pm; u.x1 = pn; u.x2 = 0; return true; }
        case PH_WOUT: { if (Ll >= 64 * 4) return false; int pm, pn; tile_of((int)Ll, 64, 4, pm, pn);
            u.a0 = (const char*)ws + WS_Z + (size_t)pm * 256 * 2048; u.a1 = u.a0 + 128 * 2048; u.sa = 2048;
            u.b0 = (const char*)ws + WS_WOUT + (size_t)pn * 256 * 2048; u.b1 = u.b0 + 128 * 2048; u.sb = 2048;
            u.kind = KIND_Y; u.x0 = pm; u.x1 = pn; u.x2 = __float_as_int(1.0f); return true; }
        case PH_WO: { if (Ll >= 64 * 4) return false; int pm, pn; tile_of((int)Ll, 64, 4, pm, pn);
            u.a0 = (const char*)ws + WS_O + (size_t)pm * 256 * 1024; u.a1 = u.a0 + 128 * 1024; u.sa = 1024;
            u.b0 = (const char*)ws + WS_WO + (size_t)pn * 256 * 1024; u.b1 = u.b0 + 128 * 1024; u.sb = 1024;
            u.kind = KIND_Y; u.x0 = pm; u.x1 = pn; u.x2 = __float_as_int(1.0f); return true; }
        case PH_KVG1: {
            if (Ll >= 780 + 1430) return false;
            if (Ll >= 780) { fill_g1((int)Ll - 780, u); return true; }
            int T, cc; tile_of((int)Ll, 65, 12, T, cc);
            const int g = cc >> 2, part = (cc >> 1) & 1, j = cc & 1; int row0, step; dil_tile(g, T, row0, step);
            const char* x0 = (const char*)ws + WS_XN + (size_t)row0 * 2048; const char* x1 = x0 + (size_t)(128 * step) * 2048;
            const char* w0 = (const char*)ws + WS_WKV + (size_t)(g * 1024 + part * 512 + j * 256) * 2048; const char* w1 = w0 + 128 * 2048;
            if (part == 0) { u.a0 = x0; u.a1 = x1; u.sa = (unsigned)step * 2048u; u.b0 = w0; u.b1 = w1; u.sb = 2048; u.kind = KIND_K; }
            else           { u.a0 = w0; u.a1 = w1; u.sa = 2048; u.b0 = x0; u.b1 = x1; u.sb = (unsigned)step * 2048u; u.kind = KIND_VT; }
            u.x0 = g; u.x1 = T; u.x2 = j; return true; }
        case PH_Q: { if (Ll >= 65 * 6) return false; int T, cc; tile_of((int)Ll, 65, 6, T, cc);
            const int g = cc >> 1, j = cc & 1; int row0, step; dil_tile(g, T, row0, step);
            u.a0 = (const char*)ws + WS_XN + (size_t)row0 * 2048; u.a1 = u.a0 + (size_t)(128 * step) * 2048; u.sa = (unsigned)step * 2048u;
            u.b0 = (const char*)ws + WS_WQ + (size_t)(g * 512 + j * 256) * 2048; u.b1 = u.b0 + 128 * 2048; u.sb = 2048;
            u.kind = KIND_Q; u.x0 = g; u.x1 = T; u.x2 = j; return true; }
        }
        return false;
    }
};

__device__ __forceinline__ float silu_f(float g) { return g / (1.f + __expf(-g)); }
__device__ __forceinline__ void epilogue(const Params& P, const f32x4 (&acc)[2][2][4][2], const UnitD& u, int wr, int wc, int fr, int fq) {
    unsigned char* ws = P.ws;
    int rl0 = wr * 64 + fr, cl0 = wc * 32 + 8 * fq;
    asm volatile("" : "+v"(rl0), "+v"(cl0));
    if (u.kind == KIND_G1) {
        bf16_t* H = (bf16_t*)(ws + WS_H);
#pragma unroll
        for (int ai = 0; ai < 2; ++ai)
#pragma unroll
            for (int m = 0; m < 4; ++m) {
                const size_t row = (size_t)u.x0 * 256 + ai * 128 + m * 16 + rl0;
                const f32x4 g0 = acc[ai][0][m][0], g1 = acc[ai][0][m][1], u0 = acc[ai][1][m][0], u1 = acc[ai][1][m][1];
                u32x4 w; w.x = cvt_pk_bf16(silu_f(g0[0]) * u0[0], silu_f(g0[1]) * u0[1]); w.y = cvt_pk_bf16(silu_f(g0[2]) * u0[2], silu_f(g0[3]) * u0[3]);
                w.z = cvt_pk_bf16(silu_f(g1[0]) * u1[0], silu_f(g1[1]) * u1[1]); w.w = cvt_pk_bf16(silu_f(g1[2]) * u1[2], silu_f(g1[3]) * u1[3]);
                *(u32x4*)(H + row * DFF + u.x1 * 128 + cl0) = w;
            }
    } else if (u.kind == KIND_Y) {
        float* Y = (float*)(ws + WS_Y); const float sc = __int_as_float(u.x2);
#pragma unroll
        for (int ai = 0; ai < 2; ++ai)
#pragma unroll
            for (int m = 0; m < 4; ++m) {
                float* rowp = Y + ((size_t)u.x0 * 256 + ai * 128 + m * 16 + rl0) * D + u.x1 * 256 + cl0;
#pragma unroll
                for (int bj = 0; bj < 2; ++bj)
#pragma unroll
                    for (int n = 0; n < 2; ++n) *(f32x4*)(rowp + bj * 128 + n * 4) = acc[ai][bj][m][n] * sc;
            }
    } else if (u.kind == KIND_U) {
        bf16_t* U = (bf16_t*)(ws + WS_U);
#pragma unroll
        for (int ai = 0; ai < 2; ++ai)
#pragma unroll
            for (int m = 0; m < 4; ++m) {
                const int row = u.x0 * 256 + ai * 128 + m * 16 + rl0;
#pragma unroll
                for (int bj = 0; bj < 2; ++bj) {
                    const f32x4 v0 = acc[ai][bj][m][0], v1 = acc[ai][bj][m][1];
                    u32x4 w; w.x = cvt_pk_bf16(v0[0], v0[1]); w.y = cvt_pk_bf16(v0[2], v0[3]); w.z = cvt_pk_bf16(v1[0], v1[1]); w.w = cvt_pk_bf16(v1[2], v1[3]);
                    *(u32x4*)(U + (size_t)row * D + u.x1 * 256 + bj * 128 + cl0) = w;
                    const int p = row & 4095;
                    if (p >= 4081) { float* o = P.out + O_PSP + ((size_t)(row >> 12) * 15 + (p - 4081)) * D + u.x1 * 256 + bj * 128 + cl0; *(f32x4*)o = v0; *(f32x4*)(o + 4) = v1; }
                }
            }
    } else if (u.kind == KIND_Z) {
        bf16_t* Z = (bf16_t*)(ws + WS_Z); const float* scl = P.in[12];
#pragma unroll
        for (int bj = 0; bj < 2; ++bj) {
            const int col = u.x1 * 256 + bj * 128 + cl0; const f32x4 s0 = *(const f32x4*)(scl + col), s1 = *(const f32x4*)(scl + col + 4);
#pragma unroll
            for (int ai = 0; ai < 2; ++ai)
#pragma unroll
                for (int m = 0; m < 4; ++m) {
                    const size_t row = (size_t)u.x0 * 256 + ai * 128 + m * 16 + rl0;
                    const f32x4 v0 = acc[ai][bj][m][0] * s0, v1 = acc[ai][bj][m][1] * s1;
                    u32x4 w; w.x = cvt_pk_bf16(v0[0], v0[1]); w.y = cvt_pk_bf16(v0[2], v0[3]); w.z = cvt_pk_bf16(v1[0], v1[1]); w.w = cvt_pk_bf16(v1[2], v1[3]);
                    *(u32x4*)(Z + row * D + col) = w;
                }
        }
    } else if (u.kind == KIND_Q) {
        bf16_t* Q = (bf16_t*)(ws + WS_QB + (size_t)u.x0 * GRP_BYTES);
#pragma unroll
        for (int ai = 0; ai < 2; ++ai)
#pragma unroll
            for (int m = 0; m < 4; ++m) {
                const size_t row = (size_t)u.x1 * 256 + ai * 128 + m * 16 + rl0;
#pragma unroll
                for (int bj = 0; bj < 2; ++bj) {
                    const f32x4 v0 = acc[ai][bj][m][0] * QSCALE, v1 = acc[ai][bj][m][1] * QSCALE;
                    u32x4 w; w.x = cvt_pk_bf16(v0[0], v0[1]); w.y = cvt_pk_bf16(v0[2], v0[3]); w.z = cvt_pk_bf16(v1[0], v1[1]); w.w = cvt_pk_bf16(v1[2], v1[3]);
                    *(u32x4*)(Q + row * 512 + u.x2 * 256 + bj * 128 + cl0) = w;
                }
            }
    } else if (u.kind == KIND_K) {
        const int g = u.x0, T = u.x1, j = u.x2;
        bf16_t* Kb = (bf16_t*)(ws + WS_KB + (size_t)g * GRP_BYTES);
        const int sh = 2 * g, Lg = 4096 >> sh, W = 128 << sh;
        const int b = T >> 4, i0 = (T & 15) * 256, r = i0 / Lg, t0 = i0 % Lg;
        float* outp = P.out + (g == 0 ? O_KP0 : (g == 1 ? O_KP1 : O_KP2)); float* outs = P.out + (g == 0 ? O_KS0 : (g == 1 ? O_KS1 : O_KS2));
#pragma unroll
        for (int ai = 0; ai < 2; ++ai)
#pragma unroll
            for (int m = 0; m < 4; ++m) {
                const int rl = ai * 128 + m * 16 + rl0;
#pragma unroll
                for (int bj = 0; bj < 2; ++bj) {
                    const f32x4 v0 = acc[ai][bj][m][0], v1 = acc[ai][bj][m][1]; const int col = j * 256 + bj * 128 + cl0;
                    u32x4 w; w.x = cvt_pk_bf16(v0[0], v0[1]); w.y = cvt_pk_bf16(v0[2], v0[3]); w.z = cvt_pk_bf16(v1[0], v1[1]); w.w = cvt_pk_bf16(v1[2], v1[3]);
                    *(u32x4*)(Kb + ((size_t)T * 256 + rl) * 512 + col) = w;
                    if (T < 64) { const int t = t0 + rl - (Lg - 128);
                        if (t >= 0) { float* o = outp + ((size_t)b * W + r + ((size_t)t << sh)) * 1024 + col; *(f32x4*)o = v0; *(f32x4*)(o + 4) = v1; } }
                    else if (rl < NS) { float* o = outs + (size_t)rl * 1024 + col; *(f32x4*)o = v0; *(f32x4*)(o + 4) = v1; }
                }
            }
    } else {
        const int g = u.x0, T = u.x1, j = u.x2;
        bf16_t* VT = (bf16_t*)(ws + WS_VT + (size_t)g * GRP_BYTES);
        const int sh = 2 * g, Lg = 4096 >> sh, W = 128 << sh;
        const int b = T >> 4, i0 = (T & 15) * 256, r = i0 / Lg, t0 = i0 % Lg;
        float* outp = P.out + (g == 0 ? O_KP0 : (g == 1 ? O_KP1 : O_KP2)); float* outs = P.out + (g == 0 ? O_KS0 : (g == 1 ? O_KS1 : O_KS2));
#pragma unroll
        for (int ai = 0; ai < 2; ++ai)
#pragma unroll
            for (int m = 0; m < 4; ++m) {
                const int ch = j * 256 + ai * 128 + m * 16 + rl0;
#pragma unroll
                for (int bj = 0; bj < 2; ++bj) {
                    const f32x4 v0 = acc[ai][bj][m][0], v1 = acc[ai][bj][m][1]; const int tl = bj * 128 + cl0;
                    u32x4 w; w.x = cvt_pk_bf16(v0[0], v0[1]); w.y = cvt_pk_bf16(v0[2], v0[3]); w.z = cvt_pk_bf16(v1[0], v1[1]); w.w = cvt_pk_bf16(v1[2], v1[3]);
                    *(u32x4*)(VT + (size_t)ch * MP + (size_t)T * 256 + tl) = w;
                    if (T < 64) { const int t = t0 + tl - (Lg - 128);
                        if (t >= 0) { float* o = outp + ((size_t)b * W + r + ((size_t)t << sh)) * 1024 + 512 + ch; const size_t st = (size_t)1024 << sh;
#pragma unroll
                            for (int e = 0; e < 4; ++e) { o[(size_t)e * st] = v0[e]; o[(size_t)(e + 4) * st] = v1[e]; } } }
                    else if (tl < NS) { float* o = outs + (size_t)tl * 1024 + 512 + ch;
#pragma unroll
                        for (int e = 0; e < 4; ++e) { o[(size_t)e * 1024] = v0[e]; o[(size_t)(e + 4) * 1024] = v1[e]; } }
                }
            }
    }
}

template <bool ALIGN_EPI>
__device__ __forceinline__ void gemm_phase(LAS unsigned char* lds, const Params& P, const PhaseSched& S) {
    const int tid = threadIdx.x, wid = __builtin_amdgcn_readfirstlane(tid >> 6), lane = tid & 63, wr = wid >> 2, wc = wid & 3, fr = lane & 15, fq = lane >> 4;
    const int K = S.depth(), nt = K / BK;
    unsigned Rl[2], Rb[2], Cb[2];
#pragma unroll
    for (int i = 0; i < 2; ++i) { int R, C; stage_rc(tid * 16 + i * 8192, R, C); Rl[i] = (unsigned)R; Rb[i] = (unsigned)((R & ~31) + perm32(R & 31)); Cb[i] = (unsigned)C * 2u; }
    const size_t kstep = (size_t)(BK * 2);
    const unsigned ldsw = (unsigned)wid * 1024u;
    const int aoff = lds_byte(wr * 64 + fr, fq * 8), boff = lds_byte(wc * 32 + fr, fq * 8);
#define PG8_SA(b, h) (((b) * 2 + (h)) * HTB)
#define PG8_SB(b, h) ((4 + (b) * 2 + (h)) * HTB)
#define PG8_STAGE(bufoff, gbase, voff) do { _Pragma("unroll") for (int _i = 0; _i < 2; ++_i) \
        __builtin_amdgcn_global_load_lds((const unsigned*)((const char*)(gbase) + (voff)[_i]), (LAS unsigned*)(lds + (bufoff) + ldsw + _i * 8192), 16, 0, 0); } while (0)
#define PG8_LDA(dst, b, h) do { _Pragma("unroll") for (int m = 0; m < 4; ++m) _Pragma("unroll") for (int k = 0; k < 2; ++k) dst[m][k] = *(const LAS bf16x8*)(lds + PG8_SA(b, h) + aoff + m * 2048 + k * 1024); } while (0)
#define PG8_LDB(dst, b, h) do { _Pragma("unroll") for (int n = 0; n < 2; ++n) _Pragma("unroll") for (int k = 0; k < 2; ++k) dst[n][k] = *(const LAS bf16x8*)(lds + PG8_SB(b, h) + boff + n * 2048 + k * 1024); } while (0)
#define PG8_MMA(ai, bj, At, Bt) do { __builtin_amdgcn_s_setprio(1); _Pragma("unroll") for (int m = 0; m < 4; ++m) _Pragma("unroll") for (int n = 0; n < 2; ++n) _Pragma("unroll") for (int k = 0; k < 2; ++k) \
        acc[ai][bj][m][n] = __builtin_amdgcn_mfma_f32_16x16x32_bf16(Bt[n][k], At[m][k], acc[ai][bj][m][n], 0, 0, 0); __builtin_amdgcn_s_setprio(0); } while (0)
#define PG8_WAIT_V(n) asm volatile("s_waitcnt vmcnt(" #n ")" ::: "memory")
#define PG8_WAIT_L(n) asm volatile("s_waitcnt lgkmcnt(" #n ")" ::: "memory")
#define PG8_BAR __builtin_amdgcn_s_barrier()
#define PG8_SCHED __builtin_amdgcn_sched_barrier(0)
    UnitD cur, nxt; int ui = 0;
    if (!S.next(0, cur)) return;
    f32x4 acc[2][2][4][2];
#pragma unroll
    for (int a = 0; a < 2; ++a)
#pragma unroll
        for (int b = 0; b < 2; ++b)
#pragma unroll
            for (int m = 0; m < 4; ++m)
#pragma unroll
                for (int n = 0; n < 2; ++n) acc[a][b][m][n] = (f32x4){0.f, 0.f, 0.f, 0.f};
    bf16x8 At[4][2], B0[2][2], B1[2][2];
    unsigned vAc[2], vBc[2], vAn[2], vBn[2];
#pragma unroll
    for (int i = 0; i < 2; ++i) { vAc[i] = Rl[i] * cur.sa + Cb[i]; vBc[i] = Rb[i] * cur.sb + Cb[i]; vAn[i] = vAc[i]; vBn[i] = vBc[i]; }
    const char *cA0 = cur.a0, *cA1 = cur.a1, *cB0 = cur.b0, *cB1 = cur.b1;
    PG8_STAGE(PG8_SB(0, 0), cB0, vBc); PG8_STAGE(PG8_SB(0, 1), cB1, vBc); PG8_STAGE(PG8_SA(0, 0), cA0, vAc); PG8_STAGE(PG8_SA(0, 1), cA1, vAc);
    if (wr == 1) PG8_BAR;
    PG8_WAIT_V(2); PG8_BAR;
    PG8_STAGE(PG8_SB(1, 0), cB0 + kstep, vBc); PG8_STAGE(PG8_SA(1, 0), cA0 + kstep, vAc); PG8_STAGE(PG8_SB(1, 1), cB1 + kstep, vBc);
    PG8_WAIT_V(6); PG8_BAR;
    for (;;) {
        const bool has_next = S.next(ui + 1, nxt);
        const char *nA0 = has_next ? nxt.a0 : cA0, *nA1 = has_next ? nxt.a1 : cA1, *nB0 = has_next ? nxt.b0 : cB0, *nB1 = has_next ? nxt.b1 : cB1;
        for (int t = 0; t < nt; t += 2) {
            const bool last = (t == nt - 2);
            if (last && has_next) {
#pragma unroll
                for (int i = 0; i < 2; ++i) { vAn[i] = Rl[i] * nxt.sa + Cb[i]; vBn[i] = Rb[i] * nxt.sb + Cb[i]; }
            }
            const char* a1h1 = cA1 + (size_t)(t + 1) * kstep;
            const char* a2h0 = last ? nA0 : cA0 + (size_t)(t + 2) * kstep; const char* a2h1 = last ? nA1 : cA1 + (size_t)(t + 2) * kstep;
            const char* b2h0 = last ? nB0 : cB0 + (size_t)(t + 2) * kstep; const char* b2h1 = last ? nB1 : cB1 + (size_t)(t + 2) * kstep;
            const char* a3h0 = a2h0 + kstep; const char* b3h0 = b2h0 + kstep; const char* b3h1 = b2h1 + kstep;
            PG8_LDB(B0, 0, 0); PG8_LDB(B1, 0, 1); PG8_SCHED; PG8_LDA(At, 0, 0); PG8_STAGE(PG8_SA(1, 1), a1h1, vAc);
            PG8_WAIT_V(8); PG8_WAIT_L(0); PG8_BAR; PG8_MMA(0, 0, At, B0); PG8_MMA(0, 1, At, B1); PG8_BAR; PG8_SCHED;
            PG8_LDA(At, 0, 1); PG8_STAGE(PG8_SB(0, 0), b2h0, vBn); PG8_STAGE(PG8_SB(0, 1), b2h1, vBn); PG8_STAGE(PG8_SA(0, 0), a2h0, vAn);
            PG8_WAIT_V(8); PG8_WAIT_L(0); PG8_BAR; PG8_MMA(1, 0, At, B0); PG8_MMA(1, 1, At, B1); PG8_BAR; PG8_SCHED;
            PG8_LDB(B0, 1, 0); PG8_LDB(B1, 1, 1); PG8_SCHED; PG8_LDA(At, 1, 0); PG8_STAGE(PG8_SA(0, 1), a2h1, vAn);
            PG8_WAIT_V(8); PG8_WAIT_L(0); PG8_BAR; PG8_MMA(0, 0, At, B0); PG8_MMA(0, 1, At, B1); PG8_BAR; PG8_SCHED;
            PG8_LDA(At, 1, 1); PG8_STAGE(PG8_SB(1, 0), b3h0, vBn); PG8_STAGE(PG8_SB(1, 1), b3h1, vBn); PG8_STAGE(PG8_SA(1, 0), a3h0, vAn);
            PG8_WAIT_V(8); PG8_WAIT_L(0); PG8_BAR; PG8_MMA(1, 0, At, B0); PG8_MMA(1, 1, At, B1); PG8_BAR; PG8_SCHED;
        }
        if constexpr (ALIGN_EPI) { if (wr == 0) PG8_BAR; }
        epilogue(P, acc, cur, wr, wc, fr, fq);
        if (!has_next) break;
#pragma unroll
        for (int a = 0; a < 2; ++a)
#pragma unroll
            for (int b = 0; b < 2; ++b)
#pragma unroll
                for (int m = 0; m < 4; ++m)
#pragma unroll
                    for (int n = 0; n < 2; ++n) acc[a][b][m][n] = (f32x4){0.f, 0.f, 0.f, 0.f};
        cur = nxt; cA0 = nA0; cA1 = nA1; cB0 = nB0; cB1 = nB1; ++ui;
#pragma unroll
        for (int i = 0; i < 2; ++i) { vAc[i] = vAn[i]; vBc[i] = vBn[i]; }
        if constexpr (ALIGN_EPI) { if (wr == 1) PG8_BAR; }
    }
    PG8_WAIT_V(0);
    if constexpr (!ALIGN_EPI) { if (wr == 0) PG8_BAR; }
    PG8_BAR;
#undef PG8_SA
#undef PG8_SB
#undef PG8_STAGE
#undef PG8_LDA
#undef PG8_LDB
#undef PG8_MMA
#undef PG8_WAIT_V
#undef PG8_WAIT_L
#undef PG8_BAR
#undef PG8_SCHED
}
enum { MINI_Y = 0, MINI_U = 1, MINI_Z = 2 };
struct MiniD { const bf16_t* A; int lda; const bf16_t* Bt; int K; int kind; float scale; int zmode; };
__device__ __forceinline__ void sample_gemm(LAS unsigned char* lds, const Params& P, const MiniD& md, int vcu, int G) {
    const int tid = threadIdx.x, wid = __builtin_amdgcn_readfirstlane(tid >> 6), lane = tid & 63, fr = lane & 15, fq = lane >> 4;
    LAS f32x4* red = (LAS f32x4*)lds;
    for (int u = vcu; u < 256; u += G) {
        const int rb = u >> 6, cb = u & 63, row0 = NTOK + 32 * rb, col0 = 16 * cb;
        const int kw = md.K / 8, k0 = wid * kw;
        const bf16_t* a0p = md.A + (size_t)(row0 + fr) * md.lda + (md.zmode ? 256 * (col0 >> 8) : 0) + k0 + 8 * fq;
        const bf16_t* a1p = a0p + (size_t)16 * md.lda;
        const bf16_t* bp = md.Bt + (size_t)(col0 + fr) * md.K + k0 + 8 * fq;
        f32x4 acc0 = {0.f, 0.f, 0.f, 0.f}, acc1 = {0.f, 0.f, 0.f, 0.f};
        for (int k = 0; k < kw; k += 32) {
            const bf16x8 a0 = *(const bf16x8*)(a0p + k), a1 = *(const bf16x8*)(a1p + k), b = *(const bf16x8*)(bp + k);
            acc0 = __builtin_amdgcn_mfma_f32_16x16x32_bf16(b, a0, acc0, 0, 0, 0);
            acc1 = __builtin_amdgcn_mfma_f32_16x16x32_bf16(b, a1, acc1, 0, 0, 0);
        }
        red[(wid * 2 + 0) * 64 + lane] = acc0; red[(wid * 2 + 1) * 64 + lane] = acc1;
        __syncthreads();
        if (wid < 2) {
            f32x4 v = red[(0 * 2 + wid) * 64 + lane];
#pragma unroll
            for (int w = 1; w < 8; ++w) v += red[(w * 2 + wid) * 64 + lane];
            const int row = row0 + 16 * wid + fr, col = col0 + 4 * fq;
            if (md.kind == MINI_Y) { *(f32x4*)((float*)(P.ws + WS_Y) + (size_t)row * D + col) = v * md.scale; }
            else if (md.kind == MINI_U) {
                u32x2 w; w.x = cvt_pk_bf16(v[0], v[1]); w.y = cvt_pk_bf16(v[2], v[3]); *(u32x2*)((bf16_t*)(P.ws + WS_U) + (size_t)row * D + col) = w;
                const int s = row - NTOK; *(f32x4*)(P.out + O_PSS + ((size_t)(s >> 2) * 15 + 11 + (s & 3)) * D + col) = v;
            } else {
                const f32x4 sc = *(const f32x4*)(P.in[12] + col); const f32x4 z = v * sc;
                u32x2 w; w.x = cvt_pk_bf16(z[0], z[1]); w.y = cvt_pk_bf16(z[2], z[3]); *(u32x2*)((bf16_t*)(P.ws + WS_Z) + (size_t)row * D + col) = w;
            }
        }
        __syncthreads();
    }
}

__device__ __forceinline__ void transpose_item(const float* W, int K, int N, bf16_t* WT, int dest_row0, LAS float* scr, int kb, int nb, int lane) {
    const int k0 = 64 * kb, n0 = 32 * nb;
#pragma unroll 8
    for (int i = 0; i < 32; ++i) { const int kk = 2 * i + (lane >> 5); scr[kk * 33 + (lane & 31)] = W[(size_t)(k0 + kk) * N + n0 + (lane & 31)]; }
    asm volatile("s_waitcnt lgkmcnt(0)" ::: "memory");
    const int c = lane & 7;
#pragma unroll
    for (int j = 0; j < 4; ++j) { const int n = (lane >> 3) + 8 * j; const LAS float* s = scr + (8 * c) * 33 + n;
        u32x4 o; o.x = pk2(s[0 * 33], s[1 * 33]); o.y = pk2(s[2 * 33], s[3 * 33]); o.z = pk2(s[4 * 33], s[5 * 33]); o.w = pk2(s[6 * 33], s[7 * 33]);
        *(u32x4*)(WT + (size_t)(dest_row0 + n) * K + k0 + 8 * c) = o; }
    asm volatile("s_waitcnt lgkmcnt(0)" ::: "memory");
}
__device__ __forceinline__ void prologue(LAS unsigned char* lds, const Params& P, int vcu, int G) {
    const int tid = threadIdx.x, wid = __builtin_amdgcn_readfirstlane(tid >> 6), lane = tid & 63;
    LAS float* scr = (LAS float*)(lds + wid * 16384);
    const int gw = vcu * NWAVES + wid, NGW = G * NWAVES;
    constexpr int I13 = 16 * 176, I2 = 44 * 32, IIN = 16 * 32, IGRP = 4 * 8, IKV = 16 * 96, IQ = 16 * 48, IO = 8 * 32;
    constexpr int NITEMS = 4 * I13 + 4 * I2 + IIN + 4 * IGRP + IIN + IKV + IQ + IO;
    for (int it = gw; it < NITEMS; it += NGW) {
        int r = it;
        if (r < 4 * I13) { const int w = r / I13; r -= w * I13; const int kb = r / 176, nb = r % 176, n0 = nb * 32, part = n0 / DFF, j = n0 % DFF;
            transpose_item(P.in[8] + (size_t)w * D * 2 * DFF, D, 2 * DFF, (bf16_t*)(P.ws + WS_W13 + (size_t)w * W13_BYTES), 256 * (j / 128) + 128 * part + (j % 128), scr, kb, nb, lane); continue; }
        r -= 4 * I13;
        if (r < 4 * I2) { const int w = r / I2; r -= w * I2; transpose_item(P.in[9] + (size_t)w * DFF * D, DFF, D, (bf16_t*)(P.ws + WS_W2 + (size_t)w * W2_BYTES), 32 * (r % 32), scr, r / 32, r % 32, lane); continue; }
        r -= 4 * I2;
        if (r < IIN) { transpose_item(P.in[10], D, D, (bf16_t*)(P.ws + WS_WIN), 32 * (r % 32), scr, r / 32, r % 32, lane); continue; }
        r -= IIN;
        if (r < 4 * IGRP) { const int g = r / IGRP; r -= g * IGRP; transpose_item(P.in[11] + (size_t)g * 65536, 256, 256, (bf16_t*)(P.ws + WS_WGRP), g * 256 + 32 * (r % 8), scr, r / 8, r % 8, lane); continue; }
        r -= 4 * IGRP;
        if (r < IIN) { transpose_item(P.in[13], D, D, (bf16_t*)(P.ws + WS_WOUT), 32 * (r % 32), scr, r / 32, r % 32, lane); continue; }
        r -= IIN;
        if (r < IKV) { transpose_item(P.in[14], D, 3072, (bf16_t*)(P.ws + WS_WKV), 32 * (r % 96), scr, r / 96, r % 96, lane); continue; }
        r -= IKV;
        if (r < IQ) { transpose_item(P.in[15], D, 1536, (bf16_t*)(P.ws + WS_WQ), 32 * (r % 48), scr, r / 48, r % 48, lane); continue; }
        r -= IQ;
        transpose_item(P.in[16], 512, D, (bf16_t*)(P.ws + WS_WO), 32 * (r % 32), scr, r / 32, r % 32, lane);
    }
    for (int m = gw; m < MP; m += NGW) {
        unsigned long long* o8 = (unsigned long long*)((bf16_t*)(P.ws + WS_XN) + (size_t)m * D) + lane;
        if (m < NTOK + NS) {
            const f32x4* xr = (const f32x4*)(m < NTOK ? P.in[0] + (size_t)m * D : P.in[1] + (size_t)(m - NTOK) * D) + lane;
#pragma unroll
            for (int j = 0; j < 4; ++j) { const f32x4 v = xr[64 * j]; o8[64 * j] = (unsigned long long)pk2(v[0], v[1]) | ((unsigned long long)pk2(v[2], v[3]) << 32); }
        } else {
#pragma unroll
            for (int j = 0; j < 4; ++j) o8[64 * j] = 0ull;
        }
    }
    for (int i = vcu * NTHREADS + tid; i < 32 * 11 * 256; i += G * NTHREADS) {
        const int c4 = i & 255, r = (i >> 8) % 11, b = (i >> 8) / 11;
        *(f32x4*)(P.out + O_PSS + ((size_t)b * 15 + r) * D + 4 * c4) = *(const f32x4*)(P.in[2] + ((size_t)b * 15 + r + 4) * D + 4 * c4);
    }
}

struct LnD { const float* xin_p; const float* xin_s; float* xout_p; float* xout_s; const float* g; const float* b; int write_xn; };
__device__ __forceinline__ void ln_rows(const Params& P, const LnD& L, int vcu, int G) {
    const int tid = threadIdx.x, wid = tid >> 6, lane = tid & 63;
    const int gw = vcu * NWAVES + wid, NGW = G * NWAVES;
    const float* Y = (const float*)(P.ws + WS_Y);
    f32x4 gg[4], bb[4];
#pragma unroll
    for (int j = 0; j < 4; ++j) { gg[j] = ((const f32x4*)L.g)[lane + 64 * j]; bb[j] = ((const f32x4*)L.b)[lane + 64 * j]; }
    for (int m = gw; m < NTOK + NS; m += NGW) {
        const f32x4* xr = (const f32x4*)(m < NTOK ? L.xin_p + (size_t)m * D : L.xin_s + (size_t)(m - NTOK) * D) + lane;
        const f32x4* yr = (const f32x4*)(Y + (size_t)m * D) + lane;
        f32x4 v[4]; float s = 0.f;
#pragma unroll
        for (int j = 0; j < 4; ++j) { v[j] = xr[64 * j] * ALPHA + yr[64 * j]; s += (v[j][0] + v[j][1]) + (v[j][2] + v[j][3]); }
        const float mean = wave_sum(s) * (1.f / D); float q = 0.f;
#pragma unroll
        for (int j = 0; j < 4; ++j) { v[j] = v[j] - mean; q += (v[j][0] * v[j][0] + v[j][1] * v[j][1]) + (v[j][2] * v[j][2] + v[j][3] * v[j][3]); }
        const float rstd = 1.f / sqrtf(wave_sum(q) * (1.f / D) + LN_EPS);
        f32x4* xo = (f32x4*)(m < NTOK ? L.xout_p + (size_t)m * D : L.xout_s + (size_t)(m - NTOK) * D) + lane;
        unsigned long long* o8 = (unsigned long long*)((bf16_t*)(P.ws + WS_XN) + (size_t)m * D) + lane;
#pragma unroll
        for (int j = 0; j < 4; ++j) { const f32x4 o = v[j] * rstd * gg[j] + bb[j]; xo[64 * j] = o;
            if (L.write_xn) o8[64 * j] = (unsigned long long)pk2(o[0], o[1]) | ((unsigned long long)pk2(o[2], o[3]) << 32); }
    }
}

__device__ __forceinline__ void unpack8(const u32x4 w, float (&f)[8]) {
    f[0] = bf_lo(w.x); f[1] = bf_hi(w.x); f[2] = bf_lo(w.y); f[3] = bf_hi(w.y); f[4] = bf_lo(w.z); f[5] = bf_hi(w.z); f[6] = bf_lo(w.w); f[7] = bf_hi(w.w); }
__device__ __forceinline__ void pool_phase(const Params& P, int vcu, int G) {
    const bf16_t* U = (const bf16_t*)(P.ws + WS_U); bf16_t* PL = (bf16_t*)(P.ws + WS_PL);
    const int gt = vcu * NTHREADS + threadIdx.x, NT = G * NTHREADS;
    for (int it = gt; it < (NTOK / 32) * 128; it += NT) {
        const int cg = it & 127, rb = it >> 7, c0 = cg * 8, w = 2 << (c0 >> 8);
        const int row0 = rb * 32, n0 = row0 & 4095;
        float S[8] = {0.f, 0.f, 0.f, 0.f, 0.f, 0.f, 0.f, 0.f};
        for (int j = 1; j < w; ++j) if (n0 - j >= 0) { float f[8]; unpack8(*(const u32x4*)(U + (size_t)(row0 - j) * D + c0), f);
#pragma unroll
            for (int e = 0; e < 8; ++e) S[e] += f[e]; }
        for (int i = 0; i < 32; ++i) {
            const int n = n0 + i; float f[8]; unpack8(*(const u32x4*)(U + (size_t)(row0 + i) * D + c0), f);
            const float inv = 1.f / (float)((n + 1 < w) ? n + 1 : w); float o[8];
#pragma unroll
            for (int e = 0; e < 8; ++e) { S[e] += f[e]; o[e] = S[e] * inv - f[e]; }
            u32x4 pw; pw.x = pk2(o[0], o[1]); pw.y = pk2(o[2], o[3]); pw.z = pk2(o[4], o[5]); pw.w = pk2(o[6], o[7]);
            *(u32x4*)(PL + (size_t)(row0 + i) * D + c0) = pw;
            if (n - w + 1 >= 0) { float f2[8]; unpack8(*(const u32x4*)(U + (size_t)(row0 + i - w + 1) * D + c0), f2);
#pragma unroll
                for (int e = 0; e < 8; ++e) S[e] -= f2[e]; }
        }
    }
    for (int it = gt; it < 32 * 128; it += NT) {
        const int cg = it & 127, b = it >> 7, c0 = cg * 8, w = 2 << (c0 >> 8);
        const float* pf = P.in[2] + (size_t)b * 15 * D + c0;
        float S[8] = {0.f, 0.f, 0.f, 0.f, 0.f, 0.f, 0.f, 0.f};
        for (int j = 1; j < w; ++j) { const f32x4 a = *(const f32x4*)(pf + (size_t)(15 - j) * D), c = *(const f32x4*)(pf + (size_t)(15 - j) * D + 4);
            S[0] += a[0]; S[1] += a[1]; S[2] += a[2]; S[3] += a[3]; S[4] += c[0]; S[5] += c[1]; S[6] += c[2]; S[7] += c[3]; }
        const float inv = 1.f / (float)w;
        for (int i = 0; i < 4; ++i) {
            const size_t row = (size_t)NTOK + b * 4 + i; float f[8]; unpack8(*(const u32x4*)(U + row * D + c0), f); float o[8];
#pragma unroll
            for (int e = 0; e < 8; ++e) { S[e] += f[e]; o[e] = S[e] * inv - f[e]; }
            u32x4 pw; pw.x = pk2(o[0], o[1]); pw.y = pk2(o[2], o[3]); pw.z = pk2(o[4], o[5]); pw.w = pk2(o[6], o[7]);
            *(u32x4*)(PL + row * D + c0) = pw;
            const int idx = i - w + 1;
            if (idx >= 0) { float f2[8]; unpack8(*(const u32x4*)(U + ((size_t)NTOK + b * 4 + idx) * D + c0), f2);
#pragma unroll
                for (int e = 0; e < 8; ++e) S[e] -= f2[e]; }
            else { const f32x4 a = *(const f32x4*)(pf + (size_t)(15 + idx) * D), c = *(const f32x4*)(pf + (size_t)(15 + idx) * D + 4);
                S[0] -= a[0]; S[1] -= a[1]; S[2] -= a[2]; S[3] -= a[3]; S[4] -= c[0]; S[5] -= c[1]; S[6] -= c[2]; S[7] -= c[3]; }
        }
    }
}
__device__ __forceinline__ void attn_prompt_unit(const Params& P, LAS float* btab, int g, int b, int r, int tb, int h, int lane) {
    const int r32 = lane & 31, hi = lane >> 5, sh = 2 * g, Lg = 4096 >> sh, t0 = 32 * tb, R0 = b * 4096 + r * Lg;
    const bf16_t* Qg = (const bf16_t*)(P.ws + WS_QB + (size_t)g * GRP_BYTES);
    const bf16_t* Kg = (const bf16_t*)(P.ws + WS_KB + (size_t)g * GRP_BYTES);
    const bf16_t* Vg = (const bf16_t*)(P.ws + WS_VT + (size_t)g * GRP_BYTES);
    { const float* rb = P.in[17] + g * 8 + h;
      btab[lane] = rb[BUCKET[g][lane] * 24] * LOG2E; btab[lane + 64] = rb[BUCKET[g][lane + 64] * 24] * LOG2E; if (lane == 0) btab[128] = rb[BUCKET[g][128] * 24] * LOG2E;
      asm volatile("s_waitcnt lgkmcnt(0)" ::: "memory"); }
    bf16x8 qf[4];
#pragma unroll
    for (int dc = 0; dc < 4; ++dc) qf[dc] = *(const bf16x8*)(Qg + (size_t)(R0 + t0 + r32) * 512 + h * 64 + 16 * dc + 8 * hi);
    float mrun = -1e30f, lrun = 0.f; f32x16 o0 = {}, o1 = {};
    for (int c = 0; c < 5; ++c) {
        const int kb = t0 - 128 + 32 * c;
        if (kb < 0) continue;
        bf16x8 kf[4];
#pragma unroll
        for (int dc = 0; dc < 4; ++dc) kf[dc] = *(const bf16x8*)(Kg + (size_t)(R0 + kb + r32) * 512 + h * 64 + 16 * dc + 8 * hi);
        u32x2 va[2][2][2];
#pragma unroll
        for (int db = 0; db < 2; ++db)
#pragma unroll
            for (int s = 0; s < 2; ++s) { const bf16_t* vp = Vg + (size_t)(h * 64 + 32 * db + r32) * MP + R0 + kb + 16 * s + 4 * hi;
                va[db][s][0] = *(const u32x2*)vp; va[db][s][1] = *(const u32x2*)(vp + 8); }
        f32x16 p = {};
#pragma unroll
        for (int dc = 0; dc < 4; ++dc) p = __builtin_amdgcn_mfma_f32_32x32x16_bf16(kf[dc], qf[dc], p, 0, 0, 0);
        float mx = -1e30f;
#pragma unroll
        for (int reg = 0; reg < 16; ++reg) {
            const int kk = (reg & 3) + 8 * (reg >> 2) + 4 * hi; int j = 128 - 32 * c + r32 - kk;
            const bool valid = (j >= 0) && (j <= 128); j = j < 0 ? 0 : (j > 128 ? 128 : j);
            const float sv = valid ? p[reg] + btab[j] : -1e30f; p[reg] = sv; mx = fmaxf(mx, sv);
        }
        mx = fmaxf(mx, __shfl_xor(mx, 32));
        const float mnew = fmaxf(mrun, mx), f = __builtin_amdgcn_exp2f(mrun - mnew); mrun = mnew;
        float ps = 0.f;
#pragma unroll
        for (int reg = 0; reg < 16; ++reg) { const float e = __builtin_amdgcn_exp2f(p[reg] - mnew); p[reg] = e; ps += e; }
        lrun = lrun * f + ps;
#pragma unroll
        for (int reg = 0; reg < 16; ++reg) { o0[reg] *= f; o1[reg] *= f; }
#pragma unroll
        for (int s = 0; s < 2; ++s) {
            u32x4 pw; pw.x = cvt_pk_bf16(p[8 * s + 0], p[8 * s + 1]); pw.y = cvt_pk_bf16(p[8 * s + 2], p[8 * s + 3]); pw.z = cvt_pk_bf16(p[8 * s + 4], p[8 * s + 5]); pw.w = cvt_pk_bf16(p[8 * s + 6], p[8 * s + 7]);
            const bf16x8 pf = __builtin_bit_cast(bf16x8, pw);
            u32x4 v0w; v0w.x = va[0][s][0].x; v0w.y = va[0][s][0].y; v0w.z = va[0][s][1].x; v0w.w = va[0][s][1].y;
            u32x4 v1w; v1w.x = va[1][s][0].x; v1w.y = va[1][s][0].y; v1w.z = va[1][s][1].x; v1w.w = va[1][s][1].y;
            o0 = __builtin_amdgcn_mfma_f32_32x32x16_bf16(__builtin_bit_cast(bf16x8, v0w), pf, o0, 0, 0, 0);
            o1 = __builtin_amdgcn_mfma_f32_32x32x16_bf16(__builtin_bit_cast(bf16x8, v1w), pf, o1, 0, 0, 0);
        }
    }
    const float ltot = lrun + __shfl_xor(lrun, 32), inv = 1.f / ltot;
    const size_t tok = (size_t)b * 4096 + r + ((size_t)(t0 + r32) << sh);
    bf16_t* og = (bf16_t*)(P.ws + WS_OG + (size_t)g * GRP_BYTES) + tok * 512 + h * 64;
#pragma unroll
    for (int rq = 0; rq < 4; ++rq) {
        u32x2 w0, w1; w0.x = cvt_pk_bf16(o0[4 * rq] * inv, o0[4 * rq + 1] * inv); w0.y = cvt_pk_bf16(o0[4 * rq + 2] * inv, o0[4 * rq + 3] * inv);
        w1.x = cvt_pk_bf16(o1[4 * rq] * inv, o1[4 * rq + 1] * inv); w1.y = cvt_pk_bf16(o1[4 * rq + 2] * inv, o1[4 * rq + 3] * inv);
        *(u32x2*)(og + 8 * rq + 4 * hi) = w0; *(u32x2*)(og + 32 + 8 * rq + 4 * hi) = w1;
    }
    if (hi == 0) ((float*)(P.ws + WS_LSE + (size_t)g * LSE_BYTES))[tok * 8 + h] = (mrun + __builtin_amdgcn_logf(ltot)) * LN2;
}
__device__ __forceinline__ void attn_sample_unit(const Params& P, int g, int b, int i, int h, int lane) {
    const int sh = 2 * g, W = 128 << sh, dil = 1 << sh;
    const float* cache = P.in[3 + g] + (size_t)b * W * 1024 + h * 64 + lane;
    const bf16_t* Kn = (const bf16_t*)(P.ws + WS_KB + (size_t)g * GRP_BYTES) + (size_t)(NTOK + b * 4) * 512 + h * 64 + lane;
    const bf16_t* Vn = (const bf16_t*)(P.ws + WS_VT + (size_t)g * GRP_BYTES) + (size_t)(h * 64 + lane) * MP + NTOK + b * 4;
    const size_t row = (size_t)NTOK + b * 4 + i;
    const float q = bf_lo(((const bf16_t*)(P.ws + WS_QB + (size_t)g * GRP_BYTES))[row * 512 + h * 64 + lane]);
    const float* rb = P.in[17] + g * 8 + h;
    float m = -1e30f, l = 0.f, acc = 0.f;
    for (int j0 = 0; j0 <= 128; j0 += 4) {
        float kv[4], vv[4], bs[4];
#pragma unroll
        for (int e = 0; e < 4; ++e) { const int j = j0 + e;
            if (j <= 128) { const int idx = W + i - j * dil;
                if (idx < W) { kv[e] = cache[(size_t)idx * 1024]; vv[e] = cache[(size_t)idx * 1024 + 512]; }
                else { kv[e] = bf_lo(Kn[(size_t)(idx - W) * 512]); vv[e] = bf_lo(Vn[idx - W]); }
                bs[e] = rb[BUCKET[g][j] * 24] * LOG2E; }
            else { kv[e] = 0.f; vv[e] = 0.f; bs[e] = -1e30f; } }
#pragma unroll
        for (int e = 0; e < 4; ++e) {
            const float s = wave_sum(q * kv[e]) + bs[e];
            const float mn = fmaxf(m, s), f = __builtin_amdgcn_exp2f(m - mn), p = __builtin_amdgcn_exp2f(s - mn);
            l = l * f + p; acc = acc * f + p * vv[e]; m = mn;
        }
    }
    ((bf16_t*)(P.ws + WS_OG + (size_t)g * GRP_BYTES))[row * 512 + h * 64 + lane] = (bf16_t)f2bf(acc / l);
    if (lane == 0) ((float*)(P.ws + WS_LSE + (size_t)g * LSE_BYTES))[row * 8 + h] = (m + __builtin_amdgcn_logf(l)) * LN2;
}
__device__ __forceinline__ void attn_phase(LAS unsigned char* lds, const Params& P, int vcu, int G) {
    const int tid = threadIdx.x, wid = __builtin_amdgcn_readfirstlane(tid >> 6), lane = tid & 63;
    LAS float* btab = (LAS float*)(lds + wid * 1024);
    for (int U = vcu; U < 1536 + 384; U += G) {
        if (U < 1536) { const int g = U >> 9, b = (U >> 7) & 3, x = U & 127, nb = (4096 >> (2 * g)) / 32, r = x / nb, tb = x % nb;
            attn_prompt_unit(P, btab, g, b, r, tb, wid, lane); }
        else { const int V = U - 1536, g = V >> 7, b = (V & 127) >> 2, i = V & 3; attn_sample_unit(P, g, b, i, wid, lane); }
    }
}
__device__ __forceinline__ void combine_phase(const Params& P, int vcu, int G) {
    const int gt = vcu * NTHREADS + threadIdx.x, NT = G * NTHREADS;
    for (int it = gt; it < (NTOK + NS) * 64; it += NT) {
        const int cg = it & 63, m = it >> 6, h = cg >> 3;
        float ls[3], o[8] = {0.f, 0.f, 0.f, 0.f, 0.f, 0.f, 0.f, 0.f};
#pragma unroll
        for (int g = 0; g < 3; ++g) ls[g] = ((const float*)(P.ws + WS_LSE + (size_t)g * LSE_BYTES))[(size_t)m * 8 + h];
        const float mx = fmaxf(ls[0], fmaxf(ls[1], ls[2])); float wsum = 0.f;
#pragma unroll
        for (int g = 0; g < 3; ++g) { ls[g] = __expf(ls[g] - mx); wsum += ls[g]; }
        const float inv = 1.f / wsum;
#pragma unroll
        for (int g = 0; g < 3; ++g) { float f[8]; unpack8(*(const u32x4*)((const bf16_t*)(P.ws + WS_OG + (size_t)g * GRP_BYTES) + (size_t)m * 512 + cg * 8), f);
#pragma unroll
            for (int e = 0; e < 8; ++e) o[e] += ls[g] * inv * f[e]; }
        u32x4 pw; pw.x = pk2(o[0], o[1]); pw.y = pk2(o[2], o[3]); pw.z = pk2(o[4], o[5]); pw.w = pk2(o[6], o[7]);
        *(u32x4*)((bf16_t*)(P.ws + WS_O) + (size_t)m * 512 + cg * 8) = pw;
    }
}

__global__ void __launch_bounds__(NTHREADS, 2) mega_fwd(Params P) {
    extern __shared__ __attribute__((aligned(16))) unsigned char lds_raw[];
    LAS unsigned char* lds = (LAS unsigned char*)lds_raw;
    cooperative_groups::grid_group grid = cooperative_groups::this_grid();
    const int G = gridDim.x, bx = blockIdx.x;
    const int vcu = (G % 8 == 0) ? (bx % 8) * (G / 8) + bx / 8 : bx;
    const int lo = P.ph_lo, hi = P.ph_hi;
    float* X = (float*)(P.ws + WS_X);
#define PH(k) (lo <= (k) && (k) < hi)
#define SYNC() grid.sync()
#define GEMM(phase, wsel_, align) do { PhaseSched S; S.ph = (phase); S.G = G; S.c = bx; S.wsel = (wsel_); S.ws = P.ws; gemm_phase<align>(lds, P, S); } while (0)
#define MINI(Aoff, lda_, Btoff, K_, kind_, scale_, zmode_) do { MiniD md; md.A = (const bf16_t*)(P.ws + (Aoff)); md.lda = (lda_); md.Bt = (const bf16_t*)(P.ws + (Btoff)); md.K = (K_); md.kind = (kind_); md.scale = (scale_); md.zmode = (zmode_); \
        sample_gemm(lds, P, md, vcu, G); } while (0)
#define LNROWS(xp, xs, op, os, layer, idx, wxn) do { LnD L; L.xin_p = (xp); L.xin_s = (xs); L.xout_p = (op); L.xout_s = (os); L.g = P.in[6] + ((layer) * 3 + (idx)) * D; L.b = P.in[7] + ((layer) * 3 + (idx)) * D; L.write_xn = (wxn); \
        ln_rows(P, L, vcu, G); } while (0)
    if (PH(0)) { prologue(lds, P, vcu, G); SYNC(); }
    if (PH(1)) { GEMM(PH_G1, 0, true); SYNC(); }
    if (PH(2)) { GEMM(PH_G2, 0, false); MINI(WS_H, DFF, WS_W2 + 0 * W2_BYTES, DFF, MINI_Y, 0.5f, 0); SYNC(); }
    if (PH(3)) { LNROWS(P.in[0], P.in[1], X, X + (size_t)NTOK * D, 0, 0, 1); SYNC(); }
    if (PH(4)) { GEMM(PH_WIN, 0, false); MINI(WS_XN, D, WS_WIN, D, MINI_U, 1.f, 0); SYNC(); }
    if (PH(5)) { pool_phase(P, vcu, G); SYNC(); }
    if (PH(6)) { GEMM(PH_Z, 0, false); MINI(WS_PL, D, WS_WGRP, 256, MINI_Z, 1.f, 1); SYNC(); }
    if (PH(7)) { GEMM(PH_WOUT, 0, false); MINI(WS_Z, D, WS_WOUT, D, MINI_Y, 1.f, 0); SYNC(); }
    if (PH(8)) { LNROWS(X, X + (size_t)NTOK * D, X, X + (size_t)NTOK * D, 0, 1, 1); SYNC(); }
    if (PH(9)) { GEMM(PH_G1, 1, true); SYNC(); }
    if (PH(10)) { GEMM(PH_G2, 1, false); MINI(WS_H, DFF, WS_W2 + 1 * W2_BYTES, DFF, MINI_Y, 0.5f, 0); SYNC(); }
    if (PH(11)) { LNROWS(X, X + (size_t)NTOK * D, X, X + (size_t)NTOK * D, 0, 2, 1); SYNC(); }
    if (PH(12)) { GEMM(PH_KVG1, 2, true); SYNC(); }
    if (PH(13)) { GEMM(PH_G2, 2, false); MINI(WS_H, DFF, WS_W2 + 2 * W2_BYTES, DFF, MINI_Y, 0.5f, 0); SYNC(); }
    if (PH(14)) { LNROWS(X, X + (size_t)NTOK * D, X, X + (size_t)NTOK * D, 1, 0, 1); SYNC(); }
    if (PH(15)) { GEMM(PH_Q, 0, true); SYNC(); }
    if (PH(16)) { attn_phase(lds, P, vcu, G); SYNC(); }
    if (PH(17)) { combine_phase(P, vcu, G); SYNC(); }
    if (PH(18)) { GEMM(PH_WO, 0, false); MINI(WS_O, 512, WS_WO, 512, MINI_Y, 1.f, 0); SYNC(); }
    if (PH(19)) { LNROWS(X, X + (size_t)NTOK * D, X, X + (size_t)NTOK * D, 1, 1, 1); SYNC(); }
    if (PH(20)) { GEMM(PH_G1, 3, true); SYNC(); }
    if (PH(21)) { GEMM(PH_G2, 3, false); MINI(WS_H, DFF, WS_W2 + 3 * W2_BYTES, DFF, MINI_Y, 0.5f, 0); SYNC(); }
    if (PH(22)) { LNROWS(X, X + (size_t)NTOK * D, P.out + O_YP, P.out + O_YS, 1, 2, 0); }
#undef PH
#undef SYNC
#undef GEMM
#undef MINI
#undef LNROWS
}
}
extern "C" void kernel_launch(void* const* d_in, const int* in_sizes, int n_in,
                              void* d_out, int out_size, void* d_ws, size_t ws_size,
                              hipStream_t stream) {
    static int grid = 0;
    if (grid == 0) {
        int dev = 0, cus = 0, per_cu = 0;
        if (hipGetDevice(&dev) != hipSuccess || hipDeviceGetAttribute(&cus, hipDeviceAttributeMultiprocessorCount, dev) != hipSuccess) { fprintf(stderr, "device query failed\n"); grid = -1; return; }
        if (hipFuncSetAttribute((const void*)mk::mega_fwd, hipFuncAttributeMaxDynamicSharedMemorySize, mk::LDS_BYTES) != hipSuccess) { fprintf(stderr, "hipFuncSetAttribute failed\n"); grid = -1; return; }
        if (hipOccupancyMaxActiveBlocksPerMultiprocessor(&per_cu, (const void*)mk::mega_fwd, mk::NTHREADS, mk::LDS_BYTES) != hipSuccess || per_cu < 1) { fprintf(stderr, "occupancy query: %d blocks/CU\n", per_cu); grid = -1; return; }
        grid = cus * per_cu;
        fprintf(stderr, "mega_fwd: %d CUs x %d blocks/CU\n", cus, per_cu);
        if (n_in != 18 || (size_t)out_size != mk::O_END) { fprintf(stderr, "unexpected n_in %d / out_size %d\n", n_in, out_size); grid = -1; return; }
    }
    if (grid < 0) return;
    const size_t mega_ws = (HYB_STAGE < 6) ? (size_t)mk::WS_END : 0;
    if (ws_size < mk::WS_END + (HYB_STAGE < 6 ? (size_t)262 * 1024 * 1024 : 0)) { fprintf(stderr, "ws too small: %zu\n", ws_size); return; }
    mk::Params p{};
    for (int i = 0; i < 18; ++i) p.in[i] = (const float*)d_in[i];
    p.out = (float*)d_out; p.ws = (unsigned char*)d_ws; p.ph_lo = 0;
    { const int ends[7] = {0, 4, 9, 12, 15, 20, 23}; p.ph_hi = ends[HYB_STAGE]; }
    void* args[] = {&p};
    hipError_t e = hipLaunchCooperativeKernel((const void*)mk::mega_fwd, dim3(grid), dim3(mk::NTHREADS), args, mk::LDS_BYTES, stream);
    if (e != hipSuccess) { fprintf(stderr, "cooperative launch failed: %s (grid %d)\n", hipGetErrorString(e), grid); return; }
#if HYB_STAGE < 6
    {
        float* nws = (float*)((unsigned char*)d_ws + mega_ws);
        const float* X = (const float*)((unsigned char*)d_ws + mk::WS_X);
        nv::forward_from(stream, d_in, (float*)d_out, nws, HYB_STAGE, X, X + (size_t)mk::NTOK * 1024, (const unsigned char*)d_ws);
    }
#endif
}
```
